# Optimizing an MI355X kernel written in HIP

```python
import jax
import jax.numpy as jnp
from jax import lax
import numpy as np

D_MODEL = 1024
BATCH = 8
SEQ = 2048
DEPTH = 1
DEC_BATCH = 128
DEC_SEQ = 4
PAST_LEN = 16384
PAGE_SIZE = 128

N_META = 16
CONV_WIDTH = 3
CONV_DIM = D_MODEL // 2
CONV_GROUPS = 8
RET_HEADS = 8
RET_HEAD_DIM = (D_MODEL // 2) // RET_HEADS
RET_DIM = RET_HEADS * RET_HEAD_DIM
MIX_DIM = CONV_DIM + RET_DIM
IN_COLS = 3 * CONV_DIM + 4 * RET_DIM
D_FF = -(-8 * D_MODEL // (3 * 256)) * 256
CHUNK = 128
ROPE_BASE = 10000.0
EPS = 1e-6
GN_EPS = 1e-5

kernel_name = 'hymba_conv_retnet_step'


def _log_gamma():
    return jnp.asarray(np.log1p(-(2.0 ** (-5.0 - np.arange(RET_HEADS)))), dtype=jnp.float32)


def _rmsnorm(x, g):
    xf = x.astype(jnp.float32)
    y = xf * lax.rsqrt(jnp.mean(xf * xf, axis=-1, keepdims=True) + EPS)
    return (y * g.astype(jnp.float32)).astype(x.dtype)


def _rope(t, pos):
    half = RET_HEAD_DIM // 2
    inv = ROPE_BASE ** (-jnp.arange(half, dtype=jnp.float32) / half)
    ang = pos[:, None] * inv[None, :]
    cos = jnp.cos(ang)[None, :, None, :]
    sin = jnp.sin(ang)[None, :, None, :]
    t1, t2 = t[..., :half], t[..., half:]
    return jnp.concatenate([t1 * cos - t2 * sin, t1 * sin + t2 * cos], axis=-1)


def _retention_block(S, q, k, v, log_gamma):
    L = q.shape[1]
    idx = jnp.arange(L, dtype=jnp.float32)
    diff = idx[:, None] - idx[None, :]
    decay = jnp.where(diff[None] >= 0,
                      jnp.exp(jnp.maximum(diff, 0.0)[None] * log_gamma[:, None, None]), 0.0)
    scores = jnp.einsum('nihd,njhd->nhij', q, k) * decay[None]
    intra = jnp.einsum('nhij,njhe->nihe', scores, v)
    q_decay = jnp.exp((idx + 1.0)[:, None] * log_gamma[None, :])
    cross = jnp.einsum('nihd,nhde->nihe', q * q_decay[None, :, :, None], S)
    k_decay = jnp.exp((L - 1.0 - idx)[:, None] * log_gamma[None, :])
    S_new = (jnp.exp(L * log_gamma)[None, :, None, None] * S
             + jnp.einsum('njhd,njhe->nhde', k * k_decay[None, :, :, None], v))
    return intra + cross, S_new


def _retention(q, k, v, S0, log_gamma):
    N, L, H, D = q.shape
    lead = L % CHUNK
    outs = []
    S = S0
    if lead:
        o, S = _retention_block(S, q[:, :lead], k[:, :lead], v[:, :lead], log_gamma)
        outs.append(o)
    n_chunks = (L - lead) // CHUNK
    if n_chunks:
        def split(t):
            return t[:, lead:].reshape(N, n_chunks, CHUNK, H, D).swapaxes(0, 1)

        def step(S_c, qkv):
            o_c, S_c = _retention_block(S_c, qkv[0], qkv[1], qkv[2], log_gamma)
            return S_c, o_c

        S, o = lax.scan(step, S, (split(q), split(k), split(v)))
        outs.append(o.swapaxes(0, 1).reshape(N, n_chunks * CHUNK, H, D))
    return jnp.concatenate(outs, axis=1), S


def _layer(x, pos, conv_buf, ret_state, log_gamma, norm1_g, w_in, w_conv, ret_norm_g, w_out,
           norm2_g, w_gate, w_up, w_down):
    N, L, _ = x.shape
    xn = _rmsnorm(x, norm1_g)
    z = xn @ w_in
    cuts = [CONV_DIM, 2 * CONV_DIM, 3 * CONV_DIM, 3 * CONV_DIM + RET_DIM,
            3 * CONV_DIM + 2 * RET_DIM, 3 * CONV_DIM + 3 * RET_DIM]
    b_gate, c_gate, h, q, k, v, g = jnp.split(z, cuts, axis=-1)

    u = c_gate * h
    ext = jnp.concatenate([conv_buf.astype(u.dtype), u], axis=1)
    conv = sum(w_conv[j] * ext[:, j:j + L] for j in range(CONV_WIDTH))
    conv_out = b_gate * conv
    new_conv_buf = ext[:, L:]

    qh = _rope(q.astype(jnp.float32).reshape(N, L, RET_HEADS, RET_HEAD_DIM), pos)
    kh = _rope(k.astype(jnp.float32).reshape(N, L, RET_HEADS, RET_HEAD_DIM), pos) * (RET_HEAD_DIM ** -0.5)
    vh = v.astype(jnp.float32).reshape(N, L, RET_HEADS, RET_HEAD_DIM)
    o, S_new = _retention(qh, kh, vh, ret_state.astype(jnp.float32), log_gamma)
    mu = jnp.mean(o, axis=-1, keepdims=True)
    var = jnp.mean(jnp.square(o - mu), axis=-1, keepdims=True)
    o = ((o - mu) * lax.rsqrt(var + GN_EPS)).reshape(N, L, RET_DIM) * ret_norm_g.astype(jnp.float32)
    ret_out = (jax.nn.silu(g.astype(jnp.float32)) * o).astype(x.dtype)

    x = x + jnp.concatenate([conv_out, ret_out], axis=-1) @ w_out
    xn = _rmsnorm(x, norm2_g)
    x = x + (jax.nn.silu(xn @ w_gate) * (xn @ w_up)) @ w_down
    return x, new_conv_buf, S_new.astype(x.dtype)


def setup_inputs(seed: int = 0) -> dict:
    key = jax.random.key(seed)
    ks = jax.random.split(key, 16)
    f32 = jnp.float32

    def nrm(k, shape, scale):
        return jax.random.normal(k, shape, f32) * scale

    return {
        'x_prompt': nrm(ks[0], (BATCH, SEQ, D_MODEL), 1.0),
        'x_sample': nrm(ks[1], (DEC_BATCH, DEC_SEQ, D_MODEL), 1.0),
        'state_conv': nrm(ks[2], (DEPTH, DEC_BATCH, CONV_WIDTH - 1, CONV_DIM), 1.0),
        'state_ret': nrm(ks[3], (DEPTH, DEC_BATCH, RET_HEADS, RET_HEAD_DIM, RET_HEAD_DIM), 1.0),
        'meta_tokens': nrm(ks[4], (N_META, D_MODEL), 1.0),
        'norm1_g': 1.0 + nrm(ks[5], (DEPTH, D_MODEL), 0.02),
        'w_in': nrm(ks[6], (DEPTH, D_MODEL, IN_COLS), D_MODEL ** -0.5),
        'w_conv': nrm(ks[7], (DEPTH, CONV_WIDTH, CONV_DIM), CONV_WIDTH ** -0.5),
        'ret_norm_g': 1.0 + nrm(ks[8], (DEPTH, RET_DIM), 0.02),
        'w_out': nrm(ks[9], (DEPTH, MIX_DIM, D_MODEL), MIX_DIM ** -0.5),
        'norm2_g': 1.0 + nrm(ks[10], (DEPTH, D_MODEL), 0.02),
        'w_gate': nrm(ks[11], (DEPTH, D_MODEL, D_FF), D_MODEL ** -0.5),
        'w_up': nrm(ks[12], (DEPTH, D_MODEL, D_FF), D_MODEL ** -0.5),
        'w_down': nrm(ks[13], (DEPTH, D_FF, D_MODEL), D_FF ** -0.5),
        'final_norm_g': 1.0 + nrm(ks[14], (D_MODEL,), 0.02),
    }


def reference(x_prompt, x_sample, state_conv, state_ret, meta_tokens, norm1_g, w_in, w_conv,
              ret_norm_g, w_out, norm2_g, w_gate, w_up, w_down, final_norm_g):
    log_gamma = _log_gamma()
    n_p = x_prompt.shape[0]
    meta = jnp.broadcast_to(meta_tokens.astype(x_prompt.dtype)[None], (n_p, N_META, D_MODEL))
    xp = jnp.concatenate([meta, x_prompt], axis=1)
    xs = x_sample
    pos_p = jnp.arange(xp.shape[1], dtype=jnp.float32)
    pos_s = PAST_LEN + jnp.arange(xs.shape[1], dtype=jnp.float32)
    conv_p, ret_p, conv_s, ret_s = [], [], [], []
    for l in range(DEPTH):
        params = (norm1_g[l], w_in[l], w_conv[l], ret_norm_g[l], w_out[l], norm2_g[l],
                  w_gate[l], w_up[l], w_down[l])
        zero_conv = jnp.zeros((n_p, CONV_WIDTH - 1, CONV_DIM), xp.dtype)
        zero_ret = jnp.zeros((n_p, RET_HEADS, RET_HEAD_DIM, RET_HEAD_DIM), jnp.float32)
        xp, cb_p, rs_p = _layer(xp, pos_p, zero_conv, zero_ret, log_gamma, *params)
        xs, cb_s, rs_s = _layer(xs, pos_s, state_conv[l], state_ret[l], log_gamma, *params)
        conv_p.append(cb_p)
        ret_p.append(rs_p)
        conv_s.append(cb_s)
        ret_s.append(rs_s)
    y_prompt = _rmsnorm(xp, final_norm_g)[:, N_META:]
    y_sample = _rmsnorm(xs, final_norm_g)
    return (y_prompt, y_sample, jnp.stack(conv_p), jnp.stack(ret_p), jnp.stack(conv_s), jnp.stack(ret_s))
```

```cpp
#include <hip/hip_runtime.h>
#include <cstdio>
#include <cstdint>

constexpr int D = 1024, BATCH = 8, SEQ = 2048, NMETA = 16, LP = SEQ + NMETA  , DECB = 128, DECS = 4, PAST = 16384;
constexpr int MP = BATCH * LP  , MS = DECB * DECS  , M1 = MP + MS  , M1P = 17152  ;
constexpr int M2 = BATCH * SEQ + MS  ;
constexpr int NIN = 3584, ZC = 3072, FF = 2816, NGU = 2 * FF  , RH = 8;
constexpr int ZB = 0, ZU = 512, ZQ = 1024, ZK = 1536, ZV = 2048, ZG = 2560;
constexpr int NPOS = LP + DECS;
constexpr float EPS = 1e-6f, GN_EPS = 1e-5f;
constexpr int CH = 128, NCH = 17;

typedef unsigned short bf16_t;
typedef float f32x4 __attribute__((ext_vector_type(4)));
typedef unsigned u32x4 __attribute__((ext_vector_type(4)));
typedef unsigned u32x2 __attribute__((ext_vector_type(2)));

__device__ __forceinline__ unsigned f2bf(float f) { unsigned u = __builtin_bit_cast(unsigned, f); return (u + 0x7fffu + ((u >> 16) & 1u)) >> 16; }
__device__ __forceinline__ float bf2f(unsigned h) { return __builtin_bit_cast(float, h << 16); }
__device__ __forceinline__ unsigned pk2(float lo, float hi) { return f2bf(lo) | (f2bf(hi) << 16); }
__device__ __forceinline__ float wave_sum(float v) {
#pragma unroll
    for (int o = 1; o < 64; o <<= 1) v += __shfl_xor(v, o);
    return v;
}
__device__ __forceinline__ float siluf(float g) { return g / (1.f + __expf(-g)); }
__device__ __forceinline__ float nl2g(int h) { return -log2f(1.0f - exp2f(-5.0f - (float)h)); }

constexpr size_t MiB = 1u << 20;
constexpr size_t WS_CTL = 0, CTL_ZERO_BYTES = 1 * MiB;
constexpr size_t WS_WIN = 1 * MiB;
constexpr size_t WS_WOUT = 8 * MiB;
constexpr size_t WS_WGU = 10 * MiB;
constexpr size_t WS_WDN = 21 * MiB;
constexpr size_t WS_ROPE = 27 * MiB;
constexpr size_t WS_SG = 28 * MiB;
constexpr size_t WS_MIX = 36 * MiB;
constexpr size_t WS_R1 = 70 * MiB;
constexpr size_t WS_XN = WS_R1, WS_Z = WS_R1 + 34 * MiB;
constexpr size_t WS_X1B = WS_R1;
constexpr size_t WS_ACT = WS_R1 + 34 * MiB;
constexpr size_t WS_END = WS_Z + (size_t)M1P * ZC * 2;
static_assert(WS_END <= 256 * MiB, "workspace");
static_assert(WS_XN + (size_t)M1P * D * 2 <= WS_Z && WS_ACT + (size_t)M2 * FF * 2 <= WS_END, "overlays");
constexpr int CW_SS = 65536, CW_SS2 = 65536 + 32768;

struct Ptrs {
    const float *x_prompt, *x_sample, *state_conv, *state_ret, *meta, *norm1_g, *w_in, *w_conv, *ret_norm_g, *w_out, *norm2_g, *w_gate, *w_up, *w_down, *final_g;
    float* out; unsigned char* ws;
};
constexpr size_t O_YP = 0, O_YS = (size_t)BATCH * SEQ * D, O_CSP = O_YS + (size_t)MS * D, O_RSP = O_CSP + BATCH * 2 * 512, O_CSS = O_RSP + (size_t)BATCH * RH * 4096, O_RSS = O_CSS + (size_t)DECB * 2 * 512;

__device__ __forceinline__ const float* xrow_full(const Ptrs& p, int r) {
    if (r < MP) { const int b = r / LP, t = r - b * LP; return t < NMETA ? p.meta + (size_t)t * D : p.x_prompt + ((size_t)b * SEQ + (t - NMETA)) * D; }
    return p.x_sample + (size_t)(r - MP) * D;
}
__device__ __forceinline__ const float* xrow_compact(const Ptrs& p, int r2) { return r2 < BATCH * SEQ ? p.x_prompt + (size_t)r2 * D : p.x_sample + (size_t)(r2 - BATCH * SEQ) * D; }
__device__ __forceinline__ void row_pos(int r, int& posidx, int& jl) {
    if (r < MP) { const int b = r / LP, t = r - b * LP; posidx = t; jl = (t + 112) & 127; }
    else if (r < M1) { posidx = LP + ((r - MP) & 3); jl = 0; }
    else { posidx = 0; jl = 0; }
}
__device__ __forceinline__ int win_src(int np, float& sc) {
    const int tile = np >> 8, x = np & 255, bj = x >> 7, y = x & 127; sc = 1.f;
    if (tile < 2) return np;
    if (tile < 6) return (bj ? 1024 : 512) + 128 * (tile - 2) + y;
    if (tile < 8) return 1536 + (4 * (tile - 6) + (y >> 5)) * 64 + 32 * bj + (y & 31);
    if (tile < 10) { sc = 0.125f; return 2048 + (4 * (tile - 8) + (y >> 5)) * 64 + 32 * bj + (y & 31); }
    if (tile < 12) return 2560 + 256 * (tile - 10) + x;
    return 3072 + 256 * (tile - 12) + x;
}
__constant__ double c_inv_freq[32] = {
    1.0, 0.7498942093324559, 0.5623413251903491, 0.4216965034285822, 0.31622776601683794, 0.23713737056616552, 0.1778279410038923, 0.1333521432163324,
    0.1, 0.07498942093324559, 0.05623413251903491, 0.04216965034285822, 0.031622776601683791, 0.023713737056616552, 0.01778279410038923, 0.01333521432163324,
    0.01, 0.007498942093324559, 0.005623413251903491, 0.004216965034285822, 0.0031622776601683794, 0.0023713737056616554, 0.001778279410038923, 0.001333521432163324,
    0.001, 0.0007498942093324559, 0.0005623413251903491, 0.0004216965034285822, 0.00031622776601683794, 0.00023713737056616554, 0.0001778279410038923, 0.0001333521432163324};
__device__ __forceinline__ void sincos_d(double a, float& sn, float& cs) {
    const double inv_p2 = 0.63661977236758134308, p2_hi = 1.57079632679489655800e+00, p2_lo = 6.12323399573676603587e-17;
    const double q = rint(a * inv_p2);
    double r = fma(-q, p2_hi, a); r = fma(-q, p2_lo, r);
    const double r2 = r * r;
    double s = -1.0 / 1307674368000.0;
    s = fma(s, r2, 1.0 / 6227020800.0); s = fma(s, r2, -1.0 / 39916800.0); s = fma(s, r2, 1.0 / 362880.0); s = fma(s, r2, -1.0 / 5040.0);
    s = fma(s, r2, 1.0 / 120.0); s = fma(s, r2, -1.0 / 6.0); s = fma(s * r2, r, r);
    double c = 1.0 / 20922789888000.0;
    c = fma(c, r2, -1.0 / 87178291200.0); c = fma(c, r2, 1.0 / 479001600.0); c = fma(c, r2, -1.0 / 3628800.0); c = fma(c, r2, 1.0 / 40320.0);
    c = fma(c, r2, -1.0 / 720.0); c = fma(c, r2, 1.0 / 24.0); c = fma(c, r2, -0.5); c = fma(c, r2, 1.0);
    const int qi = ((int)(long long)q) & 3;
    const double ss = (qi == 0) ? s : (qi == 1) ? c : (qi == 2) ? -s : -c;
    const double cc = (qi == 0) ? c : (qi == 1) ? -s : (qi == 2) ? -c : s;
    sn = (float)ss; cs = (float)cc;
}
__device__ __forceinline__ void rope_entry(const Ptrs& p, int idx) {
    const int pi = idx >> 5, i = idx & 31;
    const float pos = pi < LP ? (float)pi : (float)(PAST + (pi - LP));
    float sn, cs; sincos_d((double)(pos * (float)c_inv_freq[i]), sn, cs);
    float* t = (float*)(p.ws + WS_ROPE) + (size_t)pi * 64;
    t[i] = cs; t[32 + i] = sn;
}

namespace simple {
constexpr size_t PREP_W_ELEMS = (size_t)NIN * D + (size_t)D * D + (size_t)NGU * D + (size_t)D * FF;
__global__ void __launch_bounds__(256) k_prep_w(Ptrs p) {
    const size_t idx = (size_t)blockIdx.x * 256 + threadIdx.x;
    bf16_t* win = (bf16_t*)(p.ws + WS_WIN); bf16_t* wout = (bf16_t*)(p.ws + WS_WOUT); bf16_t* wgu = (bf16_t*)(p.ws + WS_WGU); bf16_t* wdn = (bf16_t*)(p.ws + WS_WDN);
    size_t i = idx;
    if (i < (size_t)NIN * D) { const int np = (int)(i / D), k = (int)(i % D); float sc; const int src = win_src(np, sc); win[i] = (bf16_t)f2bf(p.w_in[(size_t)k * NIN + src] * sc); return; } i -= (size_t)NIN * D;
    if (i < (size_t)D * D) { const int np = (int)(i / D), k = (int)(i % D); wout[i] = (bf16_t)f2bf(p.w_out[(size_t)k * D + np]); return; } i -= (size_t)D * D;
    if (i < (size_t)NGU * D) { const int np = (int)(i / D), k = (int)(i % D); const int tile = np >> 8, x = np & 255, bj = x >> 7, y = x & 127;
        const float* w = bj ? p.w_up : p.w_gate; wgu[i] = (bf16_t)f2bf(w[(size_t)k * FF + 128 * tile + y] * p.norm2_g[k]); return; } i -= (size_t)NGU * D;
    if (i < (size_t)D * FF) { const int np = (int)(i / FF), k = (int)(i % FF); wdn[i] = (bf16_t)f2bf(p.w_down[(size_t)k * D + np]); return; }
}
__global__ void __launch_bounds__(256) k_xn(Ptrs p) {
    const int w = (blockIdx.x * 256 + threadIdx.x) >> 6, lane = threadIdx.x & 63;
    if (w >= M1P) return;
    bf16_t* o = (bf16_t*)(p.ws + WS_XN) + (size_t)w * D;
    if (w >= M1) { for (int i = lane; i < D; i += 64) o[i] = 0; return; }
    const float* row = xrow_full(p, w);
    float a = 0.f;
    for (int i = lane; i < D; i += 64) { const float v = row[i]; a += v * v; }
    a = wave_sum(a);
    const float rstd = 1.0f / sqrtf(a * (1.0f / D) + EPS);
    for (int i = lane; i < D; i += 64) o[i] = (bf16_t)f2bf(row[i] * rstd * p.norm1_g[i]);
}
__global__ void __launch_bounds__(256) k_rope_table(Ptrs p) { const int idx = blockIdx.x * 256 + threadIdx.x; if (idx < NPOS * 32) rope_entry(p, idx); }

template <class Epi>
__global__ void __launch_bounds__(256) k_gemm(const bf16_t* A, const bf16_t* Bt, int K, Epi E) {
    __shared__ float As[32][65];
    __shared__ float Bs[32][65];
    const int tid = threadIdx.x, tx = tid & 15, ty = tid >> 4;
    const int tile = blockIdx.x >> 2, y0 = (blockIdx.x & 3) * 32, r0 = blockIdx.y * 64;
    float acc[4][2][2];
#pragma unroll
    for (int i = 0; i < 4; ++i) { acc[i][0][0] = acc[i][0][1] = acc[i][1][0] = acc[i][1][1] = 0.f; }
    const int lr = tid >> 2, lk = (tid & 3) * 8;
    const bf16_t* ap = A + (size_t)(r0 + lr) * K + lk;
    const int brow = 256 * tile + (lr < 32 ? y0 + lr : 128 + y0 + (lr - 32));
    const bf16_t* bp = Bt + (size_t)brow * K + lk;
    for (int k0 = 0; k0 < K; k0 += 32) {
        const u32x4 av = *(const u32x4*)(ap + k0), bv = *(const u32x4*)(bp + k0);
#pragma unroll
        for (int i = 0; i < 4; ++i) { As[lk + 2 * i][lr] = bf2f(av[i] & 0xffffu); As[lk + 2 * i + 1][lr] = bf2f(av[i] >> 16);
                                      Bs[lk + 2 * i][lr] = bf2f(bv[i] & 0xffffu); Bs[lk + 2 * i + 1][lr] = bf2f(bv[i] >> 16); }
        __syncthreads();
#pragma unroll 8
        for (int k = 0; k < 32; ++k) {
            float a[4], b[2][2];
#pragma unroll
            for (int i = 0; i < 4; ++i) a[i] = As[k][ty * 4 + i];
#pragma unroll
            for (int j = 0; j < 2; ++j) { b[0][j] = Bs[k][tx * 2 + j]; b[1][j] = Bs[k][32 + tx * 2 + j]; }
#pragma unroll
            for (int i = 0; i < 4; ++i)
#pragma unroll
                for (int j = 0; j < 2; ++j) { acc[i][0][j] += a[i] * b[0][j]; acc[i][1][j] += a[i] * b[1][j]; }
        }
        __syncthreads();
    }
#pragma unroll
    for (int i = 0; i < 4; ++i)
#pragma unroll
        for (int j = 0; j < 2; ++j) E(r0 + ty * 4 + i, tile, y0 + tx * 2 + j, acc[i][0][j], acc[i][1][j]);
}
struct EpiZ {
    Ptrs p;
    __device__ void operator()(int r, int tile, int y, float v0, float v1) const {
        bf16_t* z = (bf16_t*)(p.ws + WS_Z) + (size_t)r * ZC;
        if (tile < 2) { z[ZB + 256 * tile + y] = (bf16_t)f2bf(v0); z[ZB + 256 * tile + 128 + y] = (bf16_t)f2bf(v1); }
        else if (tile < 6) z[ZU + 128 * (tile - 2) + y] = (bf16_t)f2bf(v0 * v1);
        else if (tile < 10) {
            const bool isk = tile >= 8; const int head = 4 * (tile - (isk ? 8 : 6)) + (y >> 5), ii = y & 31;
            int posidx, jl; row_pos(r, posidx, jl);
            const float* t = (const float*)(p.ws + WS_ROPE) + (size_t)posidx * 64;
            const float cs = t[ii], sn = t[32 + ii];
            const float sc = isk ? exp2f((float)jl * nl2g(head)) : 1.f;
            bf16_t* o = z + (isk ? ZK : ZQ) + head * 64;
            o[ii] = (bf16_t)f2bf((v0 * cs - v1 * sn) * sc); o[32 + ii] = (bf16_t)f2bf((v0 * sn + v1 * cs) * sc);
        }
        else if (tile < 12) { z[ZV + 256 * (tile - 10) + y] = (bf16_t)f2bf(v0); z[ZV + 256 * (tile - 10) + 128 + y] = (bf16_t)f2bf(v1); }
        else { z[ZG + 256 * (tile - 12) + y] = (bf16_t)f2bf(siluf(v0)); z[ZG + 256 * (tile - 12) + 128 + y] = (bf16_t)f2bf(siluf(v1)); }
    }
};
struct EpiX1 {
    Ptrs p;
    __device__ void operator()(int r, int tile, int y, float v0, float v1) const {
        const float* xr = xrow_compact(p, r); float* o = p.out + (size_t)r * D; bf16_t* xb = (bf16_t*)(p.ws + WS_X1B) + (size_t)r * D;
        const int c0 = 256 * tile + y, c1 = c0 + 128;
        const float a = xr[c0] + v0, b = xr[c1] + v1;
        o[c0] = a; o[c1] = b; xb[c0] = (bf16_t)f2bf(a); xb[c1] = (bf16_t)f2bf(b);
        atomicAdd((float*)(p.ws + WS_CTL) + CW_SS + r, a * a + b * b);
    }
};
struct EpiGU {
    Ptrs p;
    __device__ void operator()(int r, int tile, int y, float v0, float v1) const {
        const float ss = ((const float*)(p.ws + WS_CTL))[CW_SS + r];
        const float rstd = 1.0f / sqrtf(ss * (1.0f / D) + EPS);
        ((bf16_t*)(p.ws + WS_ACT))[(size_t)r * FF + 128 * tile + y] = (bf16_t)f2bf(siluf(v0 * rstd) * (v1 * rstd));
    }
};
struct EpiX2 {
    Ptrs p;
    __device__ void operator()(int r, int tile, int y, float v0, float v1) const {
        float* o = p.out + (size_t)r * D; const int c0 = 256 * tile + y, c1 = c0 + 128;
        const float a = o[c0] + v0, b = o[c1] + v1;
        o[c0] = a * p.final_g[c0]; o[c1] = b * p.final_g[c1];
        atomicAdd((float*)(p.ws + WS_CTL) + CW_SS2 + r, a * a + b * b);
    }
};
__global__ void __launch_bounds__(256) k_conv(Ptrs p) {
    const int idx = blockIdx.x * 256 + threadIdx.x;
    if (idx >= M1 * 512) return;
    const int r = idx >> 9, ch = idx & 511;
    const bf16_t* Z = (const bf16_t*)(p.ws + WS_Z);
    int smp, n, t; if (r < MP) { smp = 0; n = r / LP; t = r - n * LP; } else { smp = 1; n = (r - MP) >> 2; t = (r - MP) & 3; }
    const int L = smp ? DECS : LP;
    auto u = [&](int tt) -> float { const int ta = t + tt; if (ta >= 0) return bf2f(Z[(size_t)(r + tt) * ZC + ZU + ch]); return smp ? p.state_conv[((size_t)n * 2 + (2 + ta)) * 512 + ch] : 0.f; };
    const float u0 = u(0), u1 = u(-1), u2 = u(-2);
    if (t >= L - 2) { float* o = p.out + (smp ? O_CSS : O_CSP); o[((size_t)n * 2 + (t - (L - 2))) * 512 + ch] = u0; }
    if (!smp && t < NMETA) return;
    const int r2 = smp ? BATCH * SEQ + (r - MP) : n * SEQ + (t - NMETA);
    const float conv = p.w_conv[ch] * u2 + p.w_conv[512 + ch] * u1 + p.w_conv[1024 + ch] * u0;
    ((bf16_t*)(p.ws + WS_MIX))[(size_t)r2 * D + ch] = (bf16_t)f2bf(bf2f(Z[(size_t)r * ZC + ZB + ch]) * conv);
}
__global__ void __launch_bounds__(256) k_retention(Ptrs p) {
    __shared__ float sq[64], sk[64], sv[64], red[4][64], so[64];
    const int blk = blockIdx.x, tid = threadIdx.x, e = tid & 63, dg = tid >> 6;
    int smp, n, h;
    if (blk < BATCH * RH) { smp = 0; n = blk / RH; h = blk % RH; } else { smp = 1; n = (blk - BATCH * RH) / RH; h = (blk - BATCH * RH) % RH; }
    const int L = smp ? DECS : LP, rbase = smp ? MP + n * DECS : n * LP;
    const float gamma = 1.0f - exp2f(-5.0f - (float)h), l2g = -nl2g(h);
    const bf16_t* Z = (const bf16_t*)(p.ws + WS_Z);
    float S[16];
#pragma unroll
    for (int i = 0; i < 16; ++i) S[i] = smp ? p.state_ret[(((size_t)n * RH + h) * 64 + (dg * 16 + i)) * 64 + e] : 0.f;
    for (int t = 0; t < L; ++t) {
        const bf16_t* zr = Z + (size_t)(rbase + t) * ZC + h * 64;
        int posidx, jl; row_pos(rbase + t, posidx, jl);
        if (tid < 64) sq[tid] = bf2f(zr[ZQ + tid]); else if (tid < 128) sk[tid - 64] = bf2f(zr[ZK + tid - 64]) * exp2f((float)jl * l2g); else if (tid < 192) sv[tid - 128] = bf2f(zr[ZV + tid - 128]);
        __syncthreads();
        const float ve = sv[e]; float a = 0.f;
#pragma unroll
        for (int i = 0; i < 16; ++i) { S[i] = gamma * S[i] + sk[dg * 16 + i] * ve; a += sq[dg * 16 + i] * S[i]; }
        red[dg][e] = a;
        __syncthreads();
        if (tid < 64) so[tid] = (red[0][tid] + red[1][tid]) + (red[2][tid] + red[3][tid]);
        __syncthreads();
        if (tid < 64 && (smp || t >= NMETA)) {
            const float o = so[tid], mu = wave_sum(o) * (1.f / 64.f), dv = o - mu, var = wave_sum(dv * dv) * (1.f / 64.f);
            const int r2 = smp ? BATCH * SEQ + n * DECS + t : n * SEQ + (t - NMETA);
            ((bf16_t*)(p.ws + WS_MIX))[(size_t)r2 * D + 512 + h * 64 + tid] = (bf16_t)f2bf(bf2f(zr[ZG + tid]) * (dv * (1.0f / sqrtf(var + GN_EPS)) * p.ret_norm_g[h * 64 + tid]));
        }
    }
    float* o = p.out + (smp ? O_RSS : O_RSP);
#pragma unroll
    for (int i = 0; i < 16; ++i) o[(((size_t)n * RH + h) * 64 + (dg * 16 + i)) * 64 + e] = S[i];
}
__global__ void __launch_bounds__(256) k_final(Ptrs p) {
    const int w = (blockIdx.x * 256 + threadIdx.x) >> 6, lane = threadIdx.x & 63;
    if (w >= M2) return;
    const float rstd = 1.0f / sqrtf(((const float*)(p.ws + WS_CTL))[CW_SS2 + w] * (1.0f / D) + EPS);
    f32x4* o = (f32x4*)(p.out + (size_t)w * D);
    for (int i = lane; i < D / 4; i += 64) o[i] = o[i] * rstd;
}
}


#define GAS __attribute__((address_space(1)))
#define LAS __attribute__((address_space(3)))
typedef short bf16x8 __attribute__((ext_vector_type(8)));
typedef GAS unsigned gu32;
typedef GAS unsigned long long gu64;
#define RLX_AGENT __ATOMIC_RELAXED, __HIP_MEMORY_SCOPE_AGENT
#define LDS_WAIT() asm volatile("s_waitcnt lgkmcnt(0)" ::: "memory")
#define VM_WAIT() asm volatile("s_waitcnt vmcnt(0)" ::: "memory")

namespace pg8 {
#define PG8_LAS __attribute__((address_space(3)))
typedef unsigned short bf16_t;
typedef short bf16x8 __attribute__((ext_vector_type(8)));
typedef float f32x4 __attribute__((ext_vector_type(4)));
typedef unsigned u32x4 __attribute__((ext_vector_type(4)));
constexpr int BM = 256, BK = 64, HALF = 128, HTB = HALF * BK * 2  , STAGE_BYTES = 8 * HTB, NXCD = 8, WGM = 8;

__host__ __device__ __forceinline__ int lds_byte(int r, int c) { const int st = (r >> 4) * 2 + (c >> 5), rr = r & 15, cc = c & 31, ob = rr * 64 + cc * 2; return st * 1024 + (ob ^ (((ob >> 9) & 1) << 5)); }
__host__ __device__ __forceinline__ void stage_rc(int b, int& R, int& C) { const int st = b / 1024, sb = b % 1024, swz = sb ^ (((sb >> 9) & 1) << 5); R = (st >> 1) * 16 + swz / 64; C = (st & 1) * 32 + (swz % 64) / 2; }
__host__ __device__ __forceinline__ int perm32(int rho) { const int n = rho >> 4, i = rho & 15; return 8 * (i >> 2) + 4 * n + (i & 3); }

struct Unit { int pm, pn; };
struct Gemm { const bf16_t* A; const bf16_t* Bt; int M, N, K; };

struct StaticOrder {
    int nM, nN, nwg, G, c;
    __host__ __device__ void init(int M, int N, int G_, int c_) { nM = M / BM; nN = N / BM; nwg = nM * nN; G = G_; c = c_; }
    __host__ __device__ bool next(int i, Unit& u) const {
        const long L = (long)i * G + c; if (L >= nwg) return false;
        int wgid = (int)L; { const int q = nwg / NXCD, r = nwg % NXCD, xcd = wgid % NXCD, off = wgid / NXCD; wgid = (xcd < r ? xcd * (q + 1) : r * (q + 1) + (xcd - r) * q) + off; }
        const int nig = WGM * nN, gid = wgid / nig, fm = gid * WGM, gsz = (nM - fm) < WGM ? (nM - fm) : WGM;
        u.pm = fm + ((wgid % nig) % gsz); u.pn = (wgid % nig) / gsz; return true;
    }
    __device__ __forceinline__ void a_ready(const Unit&) const {}
    __device__ __forceinline__ void done(const Unit&) const {}
};
__device__ __forceinline__ unsigned cvt_pk_bf16(float lo, float hi) { unsigned r; asm volatile("v_cvt_pk_bf16_f32 %0, %1, %2" : "=v"(r) : "v"(lo), "v"(hi)); return r; }
typedef float f32x2 __attribute__((ext_vector_type(2)));
template <class Epi, class Sched, bool ALIGN_EPI = false, bool SP2 = false>
__device__ __forceinline__ void gemm_phase(PG8_LAS unsigned char* lds, const Gemm g, const Sched& S, const Epi& E) {
    const int tid = threadIdx.x, wid = __builtin_amdgcn_readfirstlane(tid >> 6), lane = tid & 63, wr = wid >> 2, wc = wid & 3, fr = lane & 15, fq = lane >> 4;
    const int K = g.K, nt = K / BK;
    unsigned voffA[2], voffB[2];
#pragma unroll
    for (int i = 0; i < 2; ++i) { int R, C; stage_rc(tid * 16 + i * 8192, R, C); const int Rb = Epi::PERM ? ((R & ~31) + perm32(R & 31)) : R;
        voffA[i] = (unsigned)(R * K + C) * 2u; voffB[i] = (unsigned)(Rb * K + C) * 2u; }
    const size_t kstep = (size_t)(BK * 2);
    const size_t hstep = (size_t)HALF * K * 2;
    const size_t tstep = 2 * hstep;
    const unsigned ldsw = (unsigned)wid * 1024u;
    const int aoff = lds_byte(wr * 64 + fr, fq * 8), boff = lds_byte(wc * 32 + fr, fq * 8);
#define PG8_SA(b, h) (((b) * 2 + (h)) * HTB)
#define PG8_SB(b, h) ((4 + (b) * 2 + (h)) * HTB)
#define PG8_STAGE(bufoff, gbase, voff) do { _Pragma("unroll") for (int _i = 0; _i < 2; ++_i) \
        __builtin_amdgcn_global_load_lds((const unsigned*)((const char*)(gbase) + (voff)[_i]), (PG8_LAS unsigned*)(lds + (bufoff) + ldsw + _i * 8192), 16, 0, 0); } while (0)
#define PG8_LDA(dst, b, h) do { _Pragma("unroll") for (int m = 0; m < 4; ++m) _Pragma("unroll") for (int k = 0; k < 2; ++k) dst[m][k] = *(const PG8_LAS bf16x8*)(lds + PG8_SA(b, h) + aoff + m * 2048 + k * 1024); } while (0)
#define PG8_LDB(dst, b, h) do { _Pragma("unroll") for (int n = 0; n < 2; ++n) _Pragma("unroll") for (int k = 0; k < 2; ++k) dst[n][k] = *(const PG8_LAS bf16x8*)(lds + PG8_SB(b, h) + boff + n * 2048 + k * 1024); } while (0)
#define PG8_MMA(ai, bj, At, Bt) do { __builtin_amdgcn_s_setprio(1); _Pragma("unroll") for (int m = 0; m < 4; ++m) _Pragma("unroll") for (int n = 0; n < 2; ++n) _Pragma("unroll") for (int k = 0; k < 2; ++k) \
        acc[ai][bj][m][n] = __builtin_amdgcn_mfma_f32_16x16x32_bf16(Bt[n][k], At[m][k], acc[ai][bj][m][n], 0, 0, 0); __builtin_amdgcn_s_setprio(0); } while (0)
#define PG8_WAIT_V(n) asm volatile("s_waitcnt vmcnt(" #n ")" ::: "memory")
#define PG8_WAIT_L(n) asm volatile("s_waitcnt lgkmcnt(" #n ")" ::: "memory")
#define PG8_BAR __builtin_amdgcn_s_barrier()
#define PG8_SCHED __builtin_amdgcn_sched_barrier(0)
    Unit cur, nxt; int ui = 0;
    if (!S.next(0, cur)) return;
    f32x4 acc[2][2][4][2];
#pragma unroll
    for (int a = 0; a < 2; ++a)
#pragma unroll
        for (int b = 0; b < 2; ++b)
#pragma unroll
            for (int m = 0; m < 4; ++m)
#pragma unroll
                for (int n = 0; n < 2; ++n) acc[a][b][m][n] = (f32x4){0.f, 0.f, 0.f, 0.f};
    bf16x8 At[4][2], B0[2][2], B1[2][2];
    const char* cA = (const char*)g.A + (size_t)cur.pm * tstep; const char* cB = (const char*)g.Bt + (size_t)cur.pn * tstep;
    S.a_ready(cur);
    if constexpr (SP2) {
        PG8_STAGE(PG8_SB(0, 0), cB, voffB); PG8_STAGE(PG8_SB(0, 1), cB + hstep, voffB); PG8_STAGE(PG8_SA(0, 0), cA, voffA); PG8_STAGE(PG8_SA(0, 1), cA + hstep, voffA);
        if (wr == 1) PG8_BAR;
        PG8_WAIT_V(2); PG8_BAR;
        PG8_STAGE(PG8_SB(1, 0), cB + kstep, voffB); PG8_STAGE(PG8_SA(1, 0), cA + kstep, voffA); PG8_STAGE(PG8_SB(1, 1), cB + hstep + kstep, voffB);
        PG8_WAIT_V(6); PG8_BAR;
    } else {
        PG8_STAGE(PG8_SB(0, 0), cB, voffB); PG8_STAGE(PG8_SA(0, 0), cA, voffA); PG8_STAGE(PG8_SB(0, 1), cB + hstep, voffB); PG8_STAGE(PG8_SA(0, 1), cA + hstep, voffA);
        if (wr == 1) PG8_BAR;
        PG8_WAIT_V(4); PG8_BAR;
        PG8_STAGE(PG8_SB(1, 0), cB + kstep, voffB); PG8_STAGE(PG8_SA(1, 0), cA + kstep, voffA); PG8_STAGE(PG8_SB(1, 1), cB + hstep + kstep, voffB);
        PG8_WAIT_V(6); PG8_BAR;
    }
    for (;;) {
        const bool has_next = S.next(ui + 1, nxt);
        const char* nA = has_next ? (const char*)g.A + (size_t)nxt.pm * tstep : cA; const char* nB = has_next ? (const char*)g.Bt + (size_t)nxt.pn * tstep : cB;
        for (int t = 0; t < nt; t += 2) {
            const bool last = (t == nt - 2);
            const char* a1 = cA + (size_t)(t + 1) * kstep;
            const char* a2 = last ? nA : cA + (size_t)(t + 2) * kstep; const char* b2 = last ? nB : cB + (size_t)(t + 2) * kstep;
            const char* a3 = a2 + kstep; const char* b3 = b2 + kstep;
            if (last && has_next) S.a_ready(nxt);
            if constexpr (SP2) {
            PG8_LDB(B0, 0, 0); PG8_LDB(B1, 0, 1); PG8_SCHED; PG8_LDA(At, 0, 0); PG8_STAGE(PG8_SA(1, 1), a1 + hstep, voffA);
            PG8_WAIT_V(8); PG8_WAIT_L(0); PG8_BAR; PG8_MMA(0, 0, At, B0); PG8_MMA(0, 1, At, B1); PG8_BAR; PG8_SCHED;
            PG8_LDA(At, 0, 1); PG8_STAGE(PG8_SB(0, 0), b2, voffB); PG8_STAGE(PG8_SB(0, 1), b2 + hstep, voffB); PG8_STAGE(PG8_SA(0, 0), a2, voffA);
            PG8_WAIT_V(8); PG8_WAIT_L(0); PG8_BAR; PG8_MMA(1, 0, At, B0); PG8_MMA(1, 1, At, B1); PG8_BAR; PG8_SCHED;
            PG8_LDB(B0, 1, 0); PG8_LDB(B1, 1, 1); PG8_SCHED; PG8_LDA(At, 1, 0); PG8_STAGE(PG8_SA(0, 1), a2 + hstep, voffA);
            PG8_WAIT_V(8); PG8_WAIT_L(0); PG8_BAR; PG8_MMA(0, 0, At, B0); PG8_MMA(0, 1, At, B1); PG8_BAR; PG8_SCHED;
            PG8_LDA(At, 1, 1); PG8_STAGE(PG8_SB(1, 0), b3, voffB); PG8_STAGE(PG8_SB(1, 1), b3 + hstep, voffB); PG8_STAGE(PG8_SA(1, 0), a3, voffA);
            PG8_WAIT_V(8); PG8_WAIT_L(0); PG8_BAR; PG8_MMA(1, 0, At, B0); PG8_MMA(1, 1, At, B1); PG8_BAR; PG8_SCHED;
            } else {
            PG8_LDB(B0, 0, 0); PG8_SCHED; PG8_LDA(At, 0, 0); PG8_STAGE(PG8_SA(1, 1), a1 + hstep, voffA);
            PG8_WAIT_L(8); PG8_BAR; PG8_WAIT_L(0); PG8_MMA(0, 0, At, B0); PG8_BAR; PG8_SCHED;
            PG8_LDB(B1, 0, 1); PG8_STAGE(PG8_SB(0, 0), b2, voffB);
            PG8_BAR; PG8_WAIT_L(0); PG8_MMA(0, 1, At, B1); PG8_BAR;
            PG8_LDA(At, 0, 1); PG8_STAGE(PG8_SA(0, 0), a2, voffA);
            PG8_BAR; PG8_WAIT_L(0); PG8_MMA(1, 0, At, B0); PG8_BAR; PG8_SCHED;
            PG8_STAGE(PG8_SB(0, 1), b2 + hstep, voffB);
            PG8_WAIT_V(6); PG8_BAR; PG8_MMA(1, 1, At, B1); PG8_BAR;
            PG8_LDB(B0, 1, 0); PG8_SCHED; PG8_LDA(At, 1, 0); PG8_STAGE(PG8_SA(0, 1), a2 + hstep, voffA);
            PG8_WAIT_L(8); PG8_BAR; PG8_WAIT_L(0); PG8_MMA(0, 0, At, B0); PG8_BAR; PG8_SCHED;
            PG8_LDB(B1, 1, 1); PG8_STAGE(PG8_SB(1, 0), b3, voffB);
            PG8_BAR; PG8_WAIT_L(0); PG8_MMA(0, 1, At, B1); PG8_BAR;
            PG8_LDA(At, 1, 1); PG8_STAGE(PG8_SA(1, 0), a3, voffA);
            PG8_BAR; PG8_WAIT_L(0); PG8_MMA(1, 0, At, B0); PG8_BAR; PG8_SCHED;
            PG8_STAGE(PG8_SB(1, 1), b3 + hstep, voffB);
            PG8_WAIT_V(6); PG8_BAR; PG8_MMA(1, 1, At, B1); PG8_BAR;
            }
        }
        if constexpr (ALIGN_EPI) { if (wr == 0) PG8_BAR; }
        if constexpr (!Epi::AFTER_DRAIN) { E(acc, cur, wr, wc, fr, fq); S.done(cur); }
        if (!has_next) break;
#pragma unroll
        for (int a = 0; a < 2; ++a)
#pragma unroll
            for (int b = 0; b < 2; ++b)
#pragma unroll
                for (int m = 0; m < 4; ++m)
#pragma unroll
                    for (int n = 0; n < 2; ++n) acc[a][b][m][n] = (f32x4){0.f, 0.f, 0.f, 0.f};
        cur = nxt; cA = nA; cB = nB; ++ui;
        if constexpr (ALIGN_EPI) { if (wr == 1) PG8_BAR; }
    }
    PG8_WAIT_V(0);
    if constexpr (!ALIGN_EPI) { if (wr == 0) PG8_BAR; }
    PG8_BAR;
    if constexpr (Epi::AFTER_DRAIN) { E.fused(acc, cur, wr, wc, fr, fq, lds, wid, lane); S.done(cur); }
#undef PG8_SA
#undef PG8_SB
#undef PG8_STAGE
#undef PG8_LDA
#undef PG8_LDB
#undef PG8_MMA
#undef PG8_WAIT_V
#undef PG8_WAIT_L
#undef PG8_BAR
#undef PG8_SCHED
}
}

#ifndef PG8_SP2
#define PG8_SP2 true
#endif
#ifndef PG8_ALIGN
#define PG8_ALIGN true
#endif

__device__ __forceinline__ float fast_silu(float v) { return v * __builtin_amdgcn_rcpf(1.0f + __builtin_amdgcn_exp2f(v * -1.4426950408889634f)); }
__device__ __forceinline__ u32x4 pack8(const f32x4& a, const f32x4& b) { u32x4 w; w.x = pg8::cvt_pk_bf16(a[0], a[1]); w.y = pg8::cvt_pk_bf16(a[2], a[3]); w.z = pg8::cvt_pk_bf16(b[0], b[1]); w.w = pg8::cvt_pk_bf16(b[2], b[3]); return w; }
struct FEpiZ {
    static constexpr bool PERM = true, AFTER_DRAIN = false;
    Ptrs p;
    __device__ __forceinline__ void operator()(const f32x4 (&acc)[2][2][4][2], const pg8::Unit& u, int wr, int wc, int fr, int fq) const {
        const int tile = u.pn, y8 = wc * 32 + 8 * fq, row0 = u.pm * 256 + wr * 64 + fr;
        bf16_t* Z = (bf16_t*)(p.ws + WS_Z);
        if (tile < 2 || (tile >= 10 && tile < 12)) {
            const int c0 = (tile < 2 ? ZB + 256 * tile : ZV + 256 * (tile - 10)) + y8;
#pragma unroll
            for (int ai = 0; ai < 2; ++ai)
#pragma unroll
                for (int m = 0; m < 4; ++m) { bf16_t* zr = Z + (size_t)(row0 + ai * 128 + m * 16) * ZC + c0;
                    *(u32x4*)zr = pack8(acc[ai][0][m][0], acc[ai][0][m][1]); *(u32x4*)(zr + 128) = pack8(acc[ai][1][m][0], acc[ai][1][m][1]); }
        } else if (tile >= 12) {
            const int c0 = ZG + 256 * (tile - 12) + y8;
#pragma unroll
            for (int ai = 0; ai < 2; ++ai)
#pragma unroll
                for (int m = 0; m < 4; ++m) { bf16_t* zr = Z + (size_t)(row0 + ai * 128 + m * 16) * ZC + c0;
#pragma unroll
                    for (int bj = 0; bj < 2; ++bj) { f32x4 a = acc[ai][bj][m][0], b = acc[ai][bj][m][1];
#pragma unroll
                        for (int j = 0; j < 4; ++j) { a[j] = fast_silu(a[j]); b[j] = fast_silu(b[j]); }
                        *(u32x4*)(zr + bj * 128) = pack8(a, b); } }
        } else if (tile < 6) {
            const int c0 = ZU + 128 * (tile - 2) + y8;
#pragma unroll
            for (int ai = 0; ai < 2; ++ai)
#pragma unroll
                for (int m = 0; m < 4; ++m) { bf16_t* zr = Z + (size_t)(row0 + ai * 128 + m * 16) * ZC + c0;
                    *(u32x4*)zr = pack8(acc[ai][0][m][0] * acc[ai][1][m][0], acc[ai][0][m][1] * acc[ai][1][m][1]); }
        } else {
            const bool isk = tile >= 8; const int head = 4 * (tile - (isk ? 8 : 6)) + wc, ii0 = 8 * fq;
            const float nl = isk ? nl2g(head) : 0.f;
            const int c0 = (isk ? ZK : ZQ) + head * 64 + ii0;
            const float* rt = (const float*)(p.ws + WS_ROPE);
#pragma unroll
            for (int ai = 0; ai < 2; ++ai)
#pragma unroll
                for (int m = 0; m < 4; ++m) { const int r = row0 + ai * 128 + m * 16; int posidx, jl; row_pos(r, posidx, jl);
                    const float* t = rt + (size_t)posidx * 64 + ii0;
                    const f32x4 c0v = *(const f32x4*)t, c1v = *(const f32x4*)(t + 4), s0v = *(const f32x4*)(t + 32), s1v = *(const f32x4*)(t + 36);
                    const float sc = __builtin_amdgcn_exp2f((float)jl * nl);
                    const f32x4 a0 = acc[ai][0][m][0], a1 = acc[ai][0][m][1], b0 = acc[ai][1][m][0], b1 = acc[ai][1][m][1];
                    const f32x4 o10 = (a0 * c0v - b0 * s0v) * sc, o11 = (a1 * c1v - b1 * s1v) * sc, o20 = (a0 * s0v + b0 * c0v) * sc, o21 = (a1 * s1v + b1 * c1v) * sc;
                    bf16_t* zr = Z + (size_t)r * ZC + c0;
                    *(u32x4*)zr = pack8(o10, o11); *(u32x4*)(zr + 32) = pack8(o20, o21); }
        }
    }
};
struct FEpiX1 {
    static constexpr bool PERM = false, AFTER_DRAIN = false;
    Ptrs p;
    __device__ __forceinline__ void operator()(const f32x4 (&acc)[2][2][4][2], const pg8::Unit& u, int wr, int wc, int fr, int fq) const {
        const int row0 = u.pm * 256 + wr * 64 + fr, col0 = u.pn * 256 + wc * 32 + 4 * fq;
        bf16_t* X1B = (bf16_t*)(p.ws + WS_X1B); float* SS = (float*)(p.ws + WS_CTL) + CW_SS;
#pragma unroll
        for (int ai = 0; ai < 2; ++ai)
#pragma unroll
            for (int m = 0; m < 4; ++m) { const int r = row0 + ai * 128 + m * 16; const float* xr = xrow_compact(p, r) + col0; float* o = p.out + (size_t)r * D + col0; bf16_t* xb = X1B + (size_t)r * D + col0;
                float s = 0.f;
#pragma unroll
                for (int bj = 0; bj < 2; ++bj)
#pragma unroll
                    for (int n = 0; n < 2; ++n) { const f32x4 v = *(const f32x4*)(xr + bj * 128 + n * 16) + acc[ai][bj][m][n];
                        *(f32x4*)(o + bj * 128 + n * 16) = v; u32x2 w; w.x = pg8::cvt_pk_bf16(v[0], v[1]); w.y = pg8::cvt_pk_bf16(v[2], v[3]); *(u32x2*)(xb + bj * 128 + n * 16) = w;
                        s += (v[0] * v[0] + v[1] * v[1]) + (v[2] * v[2] + v[3] * v[3]); }
                s += __shfl_xor(s, 16); s += __shfl_xor(s, 32);
                if (fq == 0) atomicAdd(SS + r, s);
                if (m & 1) asm volatile("" ::: "memory"); }
    }
};
struct FEpiGU {
    static constexpr bool PERM = true, AFTER_DRAIN = false;
    Ptrs p;
    __device__ __forceinline__ void operator()(const f32x4 (&acc)[2][2][4][2], const pg8::Unit& u, int wr, int wc, int fr, int fq) const {
        const int row0 = u.pm * 256 + wr * 64 + fr, c0 = 128 * u.pn + wc * 32 + 8 * fq;
        bf16_t* ACT = (bf16_t*)(p.ws + WS_ACT); const float* SS = (const float*)(p.ws + WS_CTL) + CW_SS;
#pragma unroll
        for (int ai = 0; ai < 2; ++ai)
#pragma unroll
            for (int m = 0; m < 4; ++m) { const int r = row0 + ai * 128 + m * 16;
                const float rstd = __builtin_amdgcn_rsqf(SS[r] * (1.0f / D) + EPS);
                f32x4 o[2];
#pragma unroll
                for (int n = 0; n < 2; ++n) { const f32x4 g = acc[ai][0][m][n] * rstd, up = acc[ai][1][m][n] * rstd;
#pragma unroll
                    for (int j = 0; j < 4; ++j) o[n][j] = fast_silu(g[j]) * up[j]; }
                *(u32x4*)(ACT + (size_t)r * FF + c0) = pack8(o[0], o[1]); }
    }
};
struct FEpiX2 {
    static constexpr bool PERM = false, AFTER_DRAIN = false;
    Ptrs p;
    __device__ __forceinline__ void operator()(const f32x4 (&acc)[2][2][4][2], const pg8::Unit& u, int wr, int wc, int fr, int fq) const {
        const int row0 = u.pm * 256 + wr * 64 + fr, col0 = u.pn * 256 + wc * 32 + 4 * fq;
        float* SS2 = (float*)(p.ws + WS_CTL) + CW_SS2;
        f32x4 fg[2][2];
#pragma unroll
        for (int bj = 0; bj < 2; ++bj)
#pragma unroll
            for (int n = 0; n < 2; ++n) fg[bj][n] = *(const f32x4*)(p.final_g + col0 + bj * 128 + n * 16);
#pragma unroll
        for (int ai = 0; ai < 2; ++ai)
#pragma unroll
            for (int m = 0; m < 4; ++m) { const int r = row0 + ai * 128 + m * 16; float* o = p.out + (size_t)r * D + col0;
                float s = 0.f;
#pragma unroll
                for (int bj = 0; bj < 2; ++bj)
#pragma unroll
                    for (int n = 0; n < 2; ++n) { const f32x4 v = *(const f32x4*)(o + bj * 128 + n * 16) + acc[ai][bj][m][n];
                        *(f32x4*)(o + bj * 128 + n * 16) = v * fg[bj][n];
                        s += (v[0] * v[0] + v[1] * v[1]) + (v[2] * v[2] + v[3] * v[3]); }
                s += __shfl_xor(s, 16); s += __shfl_xor(s, 32);
                if (fq == 0) atomicAdd(SS2 + r, s);
                if (m & 1) asm volatile("" ::: "memory"); }
    }
};

#define XB_TMO      128
#define XB_XCNT(j)  (256  + 64 * (j))
#define XB_XSUB(j)  (1280 + 64 * (j))
#define XB_XGEN(j)  (2304 + 64 * (j))
#define XB_TOP      3328
#define XB_TOPGEN   3392
#define XCD_BAR_WORDS 3456
#define XB_SPIN_CAP (1u << 18)

__device__ __forceinline__ unsigned xb_ld(unsigned* p)              { return __hip_atomic_load(p, __ATOMIC_RELAXED, __HIP_MEMORY_SCOPE_AGENT); }
__device__ __forceinline__ unsigned xb_add(unsigned* p, unsigned v) { return __hip_atomic_fetch_add(p, v, __ATOMIC_RELAXED, __HIP_MEMORY_SCOPE_AGENT); }
__device__ __forceinline__ unsigned xb_xcc_id() { return (unsigned)__builtin_amdgcn_s_getreg((3 << 11) | 20) & 0xFu; }
#define XB_SPIN(cond, bar) do { unsigned _sp = 0; while (cond) { __builtin_amdgcn_s_sleep(1); \
    if ((++_sp & 255u) == 0u) { if (xb_ld(&(bar)[XB_TMO])) break; if (_sp > XB_SPIN_CAP) { atomicAdd(&(bar)[XB_TMO], 1u); break; } } } } while (0)

struct XcdBarrier {
    unsigned* bar; unsigned x;
    volatile LAS unsigned* st;
};

__device__ __forceinline__ XcdBarrier xcd_barrier_post(unsigned* bar, volatile LAS unsigned* st) {
    XcdBarrier b; b.bar = bar; b.x = xb_xcc_id(); b.st = st;
    if (threadIdx.x == 0) (void)xb_add(&bar[XB_XCNT(b.x)], 1u);
    return b;
}
__device__ __forceinline__ void xcd_barrier_complete(unsigned* bar, unsigned x, unsigned& nloc, unsigned& nx) {
    const unsigned G = gridDim.x * gridDim.y * gridDim.z;
    unsigned sum, cnt, mine, sp = 0u;
    for (;;) {
        sum = 0u; cnt = 0u; mine = 0u;
#pragma unroll
        for (unsigned j = 0; j < 16; ++j) { const unsigned c = xb_ld(&bar[XB_XCNT(j)]); sum += c; cnt += (c > 0u) ? 1u : 0u; mine = (j == x) ? c : mine; }
        if (sum == G) break;
        __builtin_amdgcn_s_sleep(1);
        if ((++sp & 255u) == 0u) { if (xb_ld(&bar[XB_TMO])) break; if (sp > XB_SPIN_CAP) { atomicAdd(&bar[XB_TMO], 1u); break; } }
    }
    nloc = mine > 0u ? mine : 1u; nx = cnt > 0u ? cnt : 1u;
}

__device__ __forceinline__ void xcd_barrier(const XcdBarrier& b) {
    asm volatile("s_waitcnt vmcnt(0)" ::: "memory");
    __syncthreads();
    if (threadIdx.x == 0) {
        unsigned* bar = b.bar;
        __builtin_amdgcn_s_waitcnt(0);
        unsigned nloc = b.st[0], nx = b.st[1];
        if (nloc == 0u) { xcd_barrier_complete(bar, b.x, nloc, nx); b.st[0] = nloc; b.st[1] = nx; }
        const unsigned old = xb_add(&bar[XB_XSUB(b.x)], 1u);
        const unsigned gen = old / nloc;
        if (old + 1u == (gen + 1u) * nloc) {
            __builtin_amdgcn_fence(__ATOMIC_RELEASE, "agent");
            asm volatile("s_waitcnt vmcnt(0)" ::: "memory");
            const unsigned og = xb_add(&bar[XB_TOP], 1u);
            const unsigned tg = og / nx;
            if (og + 1u == (tg + 1u) * nx) xb_add(&bar[XB_TOPGEN], 1u);
            else XB_SPIN(xb_ld(&bar[XB_TOPGEN]) == tg, bar);
            __builtin_amdgcn_fence(__ATOMIC_ACQUIRE, "agent");
            xb_add(&bar[XB_XGEN(b.x)], 1u);
            asm volatile("s_waitcnt vmcnt(0)" ::: "memory");
        } else {
            XB_SPIN(xb_ld(&bar[XB_XGEN(b.x)]) == gen, bar);
            __builtin_amdgcn_fence(__ATOMIC_ACQUIRE, "agent");
            asm volatile("s_waitcnt vmcnt(0)" ::: "memory");
        }
    }
    __syncthreads();
}

constexpr int NWAVES = 8;
constexpr int RING_OFF = 0, RING_BYTES = 131072;
constexpr int LDSCTL_OFF = RING_BYTES, MISC_OFF = LDSCTL_OFF + 320;
constexpr int LDS_BYTES = 147456;
constexpr int CW_TMO = 0, CW_BAR = 4096;

struct Frame {
    LAS unsigned char* lds; volatile LAS unsigned* MISC; gu32* ctl;
    int tid, lane, wave, vcu, G;
};

__device__ __forceinline__ void p0_transpose_item(const float* W, int N, int K, int src0, float cs, const float* kg, bf16_t* WT, int n0, int k0, LAS float* scr, int lane) {
#pragma unroll 8
    for (int i = 0; i < 32; ++i) { const int kk = 2 * i + (lane >> 5); scr[kk * 33 + (lane & 31)] = W[(size_t)(k0 + kk) * N + src0 + (lane & 31)] * (kg ? kg[k0 + kk] * cs : cs); }
    LDS_WAIT(); asm volatile("" ::: "memory");
    const int c = lane & 7;
#pragma unroll
    for (int j = 0; j < 4; ++j) { const int n = (lane >> 3) + 8 * j; const LAS float* s = scr + (8 * c) * 33 + n;
        u32x4 o; o.x = pk2(s[0 * 33], s[1 * 33]); o.y = pk2(s[2 * 33], s[3 * 33]); o.z = pk2(s[4 * 33], s[5 * 33]); o.w = pk2(s[6 * 33], s[7 * 33]);
        *(GAS u32x4*)(WT + (size_t)(n0 + n) * K + k0 + 8 * c) = o; }
    LDS_WAIT(); asm volatile("" ::: "memory");
}
__device__ __forceinline__ void xn_row(const Ptrs& p, int m, int lane) {
    GAS unsigned long long* o8 = (GAS unsigned long long*)((bf16_t*)(p.ws + WS_XN) + (size_t)m * D) + lane;
    if (m >= M1) {
#pragma unroll
        for (int j = 0; j < 4; ++j) o8[64 * j] = 0ull;
        return; }
    const GAS f32x4* xr = (const GAS f32x4*)xrow_full(p, m) + lane; const GAS f32x4* gr = (const GAS f32x4*)p.norm1_g + lane;
    f32x4 v[4]; float s = 0.f;
#pragma unroll
    for (int j = 0; j < 4; ++j) { v[j] = xr[64 * j]; s += (v[j].x * v[j].x + v[j].y * v[j].y) + (v[j].z * v[j].z + v[j].w * v[j].w); }
    const float rstd = 1.f / sqrtf(wave_sum(s) * (1.f / D) + EPS);
#pragma unroll
    for (int j = 0; j < 4; ++j) { const f32x4 g = gr[64 * j]; const f32x4 w = v[j] * g * rstd; o8[64 * j] = (unsigned long long)pk2(w.x, w.y) | ((unsigned long long)pk2(w.z, w.w) << 32); }
}
__device__ __forceinline__ void p0_prologue(Frame& F, const Ptrs& p) {
    LAS float* scr = (LAS float*)(F.lds + RING_OFF + F.wave * 16384);
    const int gw = F.vcu * NWAVES + F.wave, NGW = F.G * NWAVES;
    constexpr int I_IN = 16 * 112, I_OUT = 16 * 32, I_GU = 16 * 176, I_DN = 44 * 32, NITEMS = I_IN + I_OUT + I_GU + I_DN;
    for (int it = gw; it < NITEMS; it += NGW) {
        int r = it;
        if (r < I_IN) { const int kb = r / 112, nb = r % 112; float cs; const int src0 = win_src(nb * 32, cs);
            p0_transpose_item(p.w_in, NIN, D, src0, cs, nullptr, (bf16_t*)(p.ws + WS_WIN), nb * 32, kb * 64, scr, F.lane); continue; } r -= I_IN;
        if (r < I_OUT) { const int kb = r / 32, nb = r % 32; p0_transpose_item(p.w_out, D, D, nb * 32, 1.f, nullptr, (bf16_t*)(p.ws + WS_WOUT), nb * 32, kb * 64, scr, F.lane); continue; } r -= I_OUT;
        if (r < I_GU) { const int kb = r / 176, nb = r % 176, np = nb * 32, tile = np >> 8, x = np & 255, bj = x >> 7, y = x & 127;
            p0_transpose_item(bj ? p.w_up : p.w_gate, FF, D, 128 * tile + y, 1.f, p.norm2_g, (bf16_t*)(p.ws + WS_WGU), np, kb * 64, scr, F.lane); continue; } r -= I_GU;
        { const int kb = r / 32, nb = r % 32; p0_transpose_item(p.w_down, D, FF, nb * 32, 1.f, nullptr, (bf16_t*)(p.ws + WS_WDN), nb * 32, kb * 64, scr, F.lane); }
    }
    for (int m = gw; m < M1P; m += NGW) xn_row(p, m, F.lane);
    for (int idx = gw * 64 + F.lane; idx < NPOS * 32; idx += NGW * 64) rope_entry(p, idx);
}
__device__ __forceinline__ void p_final(Frame& F, const Ptrs& p) {
    const int gw = F.vcu * NWAVES + F.wave, NGW = F.G * NWAVES;
    const float* SS2 = (const float*)(p.ws + WS_CTL) + CW_SS2;
    for (int m = gw; m < M2; m += NGW) {
        const float rstd = 1.0f / sqrtf(SS2[m] * (1.0f / D) + EPS);
        GAS f32x4* o = (GAS f32x4*)(p.out + (size_t)m * D) + F.lane;
#pragma unroll
        for (int j = 0; j < 4; ++j) o[64 * j] = o[64 * j] * rstd;
    }
}

typedef unsigned short u16;
__device__ __forceinline__ f32x4 mfma16(bf16x8 a, bf16x8 b, f32x4 c) { return __builtin_amdgcn_mfma_f32_16x16x32_bf16(a, b, c, 0, 0, 0); }
constexpr int ROWB = 144  , ROWT = 272  ;
__device__ __forceinline__ void lds_put_transposed(LAS unsigned char* img, int dg, int jl, u32x4 v) {
#pragma unroll
    for (int x = 0; x < 4; ++x) { *(LAS u16*)(img + (dg * 8 + 2 * x) * ROWT + jl * 2) = (u16)(v[x] & 0xffffu); *(LAS u16*)(img + (dg * 8 + 2 * x + 1) * ROWT + jl * 2) = (u16)(v[x] >> 16); }
}
__device__ __forceinline__ void ret_scan(Frame& F, const Ptrs& p, int bh) {
    const int b = bh >> 3, h = bh & 7, tid = F.tid, lane = F.lane, w = F.wave;
    LAS unsigned char* KT = F.lds + RING_OFF; LAS unsigned char* VT = KT + 64 * ROWT;
    const bf16_t* Z = (const bf16_t*)(p.ws + WS_Z);
    const float nl = nl2g(h), g128 = exp2f(-128.f * nl), g127 = exp2f(-127.f * nl);
    const int jl0 = tid & 127, dg0 = tid >> 7;
    u32x4 kr[2], vr[2];
    auto load_chunk = [&](int c) {
        const int t = 128 * c - 112 + jl0;
#pragma unroll
        for (int rep = 0; rep < 2; ++rep) {
            if (t >= 0) { const bf16_t* zr = Z + (size_t)(b * LP + t) * ZC + h * 64 + (dg0 + 4 * rep) * 8; kr[rep] = *(const u32x4*)(zr + ZK); vr[rep] = *(const u32x4*)(zr + ZV); }
            else { kr[rep] = (u32x4){0u, 0u, 0u, 0u}; vr[rep] = (u32x4){0u, 0u, 0u, 0u}; } }
    };
    const int dt = w >> 1, et0 = 2 * (w & 1), fr = lane & 15, fq = lane >> 4;
    f32x4 acc[2] = {(f32x4){0.f, 0.f, 0.f, 0.f}, (f32x4){0.f, 0.f, 0.f, 0.f}};
    load_chunk(0);
    for (int c = 0; c < NCH; ++c) {
#pragma unroll
        for (int rep = 0; rep < 2; ++rep) { lds_put_transposed(KT, dg0 + 4 * rep, jl0, kr[rep]); lds_put_transposed(VT, dg0 + 4 * rep, jl0, vr[rep]); }
        if (c + 1 < NCH) load_chunk(c + 1);
        LDS_WAIT(); __builtin_amdgcn_s_barrier(); asm volatile("" ::: "memory");
        acc[0] = acc[0] * g128; acc[1] = acc[1] * g128;
#pragma unroll
        for (int ks = 0; ks < 4; ++ks) {
            const bf16x8 a = *(const LAS bf16x8*)(KT + (16 * dt + fr) * ROWT + (32 * ks + 8 * fq) * 2);
            const bf16x8 b0 = *(const LAS bf16x8*)(VT + (16 * et0 + fr) * ROWT + (32 * ks + 8 * fq) * 2);
            const bf16x8 b1 = *(const LAS bf16x8*)(VT + (16 * (et0 + 1) + fr) * ROWT + (32 * ks + 8 * fq) * 2);
            acc[0] = mfma16(a, b0, acc[0]); acc[1] = mfma16(a, b1, acc[1]);
        }
        if (c + 1 < NCH) {
            bf16_t* sg = (bf16_t*)(p.ws + WS_SG) + ((size_t)(bh * 16 + c) * 64) * 64;
#pragma unroll
            for (int i = 0; i < 2; ++i) { const f32x4 v = acc[i] * g128; u32x2 o; o.x = pk2(v[0], v[1]); o.y = pk2(v[2], v[3]); *(u32x2*)(sg + (16 * (et0 + i) + fr) * 64 + 16 * dt + 4 * fq) = o; }
        } else {
            float* o = p.out + O_RSP + (size_t)bh * 4096;
#pragma unroll
            for (int i = 0; i < 2; ++i)
#pragma unroll
                for (int reg = 0; reg < 4; ++reg) o[(16 * dt + 4 * fq + reg) * 64 + 16 * (et0 + i) + fr] = acc[i][reg] * g127;
        }
        LDS_WAIT(); __builtin_amdgcn_s_barrier(); asm volatile("" ::: "memory");
    }
}
__device__ __forceinline__ void ret_sample(Frame& F, const Ptrs& p, int n) {
    const int h = F.wave, lane = F.lane;
    const float gamma = 1.0f - exp2f(-5.0f - (float)h);
    const float* s0 = p.state_ret + ((size_t)(n * RH + h) * 64) * 64 + lane;
    float S[64];
#pragma unroll
    for (int d = 0; d < 64; ++d) S[d] = s0[d * 64];
    const bf16_t* Z = (const bf16_t*)(p.ws + WS_Z); bf16_t* MIX = (bf16_t*)(p.ws + WS_MIX);
    const float gain = p.ret_norm_g[h * 64 + lane];
#pragma unroll 1
    for (int t = 0; t < DECS; ++t) {
        const bf16_t* zr = Z + (size_t)(MP + 4 * n + t) * ZC + h * 64 + lane;
        const float ql = bf2f(zr[ZQ]), kl = bf2f(zr[ZK]), vl = bf2f(zr[ZV]), gl = bf2f(zr[ZG]);
        float o = 0.f;
#pragma unroll
        for (int d = 0; d < 64; ++d) {
            const float kd = __builtin_bit_cast(float, __builtin_amdgcn_readlane(__builtin_bit_cast(int, kl), d));
            const float qd = __builtin_bit_cast(float, __builtin_amdgcn_readlane(__builtin_bit_cast(int, ql), d));
            S[d] = gamma * S[d] + kd * vl; o += qd * S[d];
        }
        const float mu = wave_sum(o) * (1.f / 64.f), dv = o - mu, var = wave_sum(dv * dv) * (1.f / 64.f);
        MIX[(size_t)(BATCH * SEQ + 4 * n + t) * D + 512 + h * 64 + lane] = (bf16_t)f2bf(gl * (dv * (1.0f / sqrtf(var + GN_EPS)) * gain));
    }
    float* so = p.out + O_RSS + ((size_t)(n * RH + h) * 64) * 64 + lane;
#pragma unroll
    for (int d = 0; d < 64; ++d) so[d * 64] = S[d];
}
__device__ __forceinline__ void conv_unit(Frame& F, const Ptrs& p, int u) {
    const int lane = F.lane, ch0 = lane * 8;
    const bf16_t* Z = (const bf16_t*)(p.ws + WS_Z); bf16_t* MIX = (bf16_t*)(p.ws + WS_MIX);
    float w0[8], w1[8], w2[8];
#pragma unroll
    for (int j = 0; j < 8; ++j) { w0[j] = p.w_conv[ch0 + j]; w1[j] = p.w_conv[512 + ch0 + j]; w2[j] = p.w_conv[1024 + ch0 + j]; }
    auto unpack8 = [](u32x4 v, float* f) {
#pragma unroll
        for (int x = 0; x < 4; ++x) { f[2 * x] = bf2f(v[x] & 0xffffu); f[2 * x + 1] = bf2f(v[x] >> 16); } };
    float um1[8], um2[8];
    const int r2s = 128 * u + 16 * F.wave;
#pragma unroll 1
    for (int i = 0; i < 16; ++i) {
        const int r2 = r2s + i;
        int smp, n, t, r;
        if (r2 < BATCH * SEQ) { smp = 0; n = r2 >> 11; t = (r2 & 2047) + NMETA; r = n * LP + t; } else { smp = 1; n = (r2 - BATCH * SEQ) >> 2; t = (r2 - BATCH * SEQ) & 3; r = MP + (r2 - BATCH * SEQ); }
        if (smp && t == 0) {
            const float* sc = p.state_conv + (size_t)n * 1024 + ch0;
#pragma unroll
            for (int j = 0; j < 8; ++j) { um2[j] = sc[j]; um1[j] = sc[512 + j]; }
        } else if (i == 0) {
            unpack8(*(const u32x4*)(Z + (size_t)(r - 1) * ZC + ZU + ch0), um1); unpack8(*(const u32x4*)(Z + (size_t)(r - 2) * ZC + ZU + ch0), um2);
        }
        float u0[8], bb[8], o[8];
        unpack8(*(const u32x4*)(Z + (size_t)r * ZC + ZU + ch0), u0); unpack8(*(const u32x4*)(Z + (size_t)r * ZC + ZB + ch0), bb);
#pragma unroll
        for (int j = 0; j < 8; ++j) o[j] = bb[j] * (w0[j] * um2[j] + w1[j] * um1[j] + w2[j] * u0[j]);
        u32x4 ov; ov.x = pk2(o[0], o[1]); ov.y = pk2(o[2], o[3]); ov.z = pk2(o[4], o[5]); ov.w = pk2(o[6], o[7]);
        *(u32x4*)(MIX + (size_t)r2 * D + ch0) = ov;
        const int L = smp ? DECS : LP;
        if (t >= L - 2) { float* so = p.out + (smp ? O_CSS : O_CSP) + ((size_t)n * 2 + (t - (L - 2))) * 512 + ch0;
            *(f32x4*)so = (f32x4){u0[0], u0[1], u0[2], u0[3]}; *(f32x4*)(so + 4) = (f32x4){u0[4], u0[5], u0[6], u0[7]}; }
#pragma unroll
        for (int j = 0; j < 8; ++j) { um2[j] = um1[j]; um1[j] = u0[j]; }
    }
}
__device__ __forceinline__ void phase_p2a(Frame& F, const Ptrs& p) {
    const int G = F.G, bx = (int)blockIdx.x;
    constexpr int NSCAN = BATCH * RH, NSAMP = DECB, NCONV = M2 / 128, NLIGHT = NSAMP + NCONV;
    const int nscanb = G > NSCAN ? NSCAN : G;
    if (bx < nscanb) for (int u = bx; u < NSCAN; u += nscanb) ret_scan(F, p, u);
    const int nl = G > NSCAN ? G - NSCAN : G, lb = G > NSCAN ? bx - NSCAN : bx;
    if (lb >= 0) for (int u = lb; u < NLIGHT; u += nl) { if (u < NSAMP) ret_sample(F, p, u); else conv_unit(F, p, u - NSAMP); }
}
__device__ __forceinline__ void phase_p2b(Frame& F, const Ptrs& p) {
    const int tid = F.tid, lane = F.lane, w = F.wave, fr = lane & 15, fq = lane >> 4;
    LAS unsigned char* Qs = F.lds + RING_OFF; LAS unsigned char* Ks = Qs + 128 * ROWB; LAS unsigned char* VT = Ks + 128 * ROWB; LAS unsigned char* SgT = VT + 64 * ROWT;
    LAS unsigned char* Ps = SgT + 64 * ROWB + w * (16 * ROWT);
    const bf16_t* Z = (const bf16_t*)(p.ws + WS_Z); bf16_t* MIX = (bf16_t*)(p.ws + WS_MIX);
    constexpr int NU = BATCH * RH * 16;
    u32x4 qr[2], kr[2], vr[2], sr;
    auto prefetch = [&](int u) {
        const int bh = u >> 4, c = (u & 15) + 1, b = bh >> 3, h = bh & 7; const size_t row0 = (size_t)b * LP + 128 * c - 112;
#pragma unroll
        for (int rep = 0; rep < 2; ++rep) { const int idx = tid + 512 * rep;
            const bf16_t* zr = Z + (row0 + (idx >> 3)) * ZC + h * 64 + (idx & 7) * 8; qr[rep] = *(const u32x4*)(zr + ZQ); kr[rep] = *(const u32x4*)(zr + ZK);
            vr[rep] = *(const u32x4*)(Z + (row0 + (idx & 127)) * ZC + ZV + h * 64 + (idx >> 7) * 8); }
        sr = *(const u32x4*)((const bf16_t*)(p.ws + WS_SG) + ((size_t)(bh * 16 + (c - 1)) * 64 + (tid >> 3)) * 64 + (tid & 7) * 8);
    };
    int u = (int)blockIdx.x;
    if (u < NU) prefetch(u);
    for (; u < NU; u += F.G) {
        const int bh = u >> 4, c = (u & 15) + 1, b = bh >> 3, h = bh & 7;
#pragma unroll
        for (int rep = 0; rep < 2; ++rep) { const int idx = tid + 512 * rep;
            *(LAS u32x4*)(Qs + (idx >> 3) * ROWB + (idx & 7) * 16) = qr[rep]; *(LAS u32x4*)(Ks + (idx >> 3) * ROWB + (idx & 7) * 16) = kr[rep];
            lds_put_transposed(VT, idx >> 7, idx & 127, vr[rep]); }
        *(LAS u32x4*)(SgT + (tid >> 3) * ROWB + (tid & 7) * 16) = sr;
        if (u + F.G < NU) prefetch(u + F.G);
        LDS_WAIT(); __builtin_amdgcn_s_barrier(); asm volatile("" ::: "memory");
        const int rg = w;
        bf16x8 bq[2];
#pragma unroll
        for (int ks = 0; ks < 2; ++ks) bq[ks] = *(const LAS bf16x8*)(Qs + (16 * rg + fr) * ROWB + (32 * ks + 8 * fq) * 2);
        for (int jt = 0; jt <= rg; ++jt) {
            f32x4 s = (f32x4){0.f, 0.f, 0.f, 0.f};
#pragma unroll
            for (int ks = 0; ks < 2; ++ks) s = mfma16(*(const LAS bf16x8*)(Ks + (16 * jt + fr) * ROWB + (32 * ks + 8 * fq) * 2), bq[ks], s);
            if (jt == rg) {
#pragma unroll
                for (int reg = 0; reg < 4; ++reg) if (4 * fq + reg > fr) s[reg] = 0.f; }
            u32x2 o; o.x = pk2(s[0], s[1]); o.y = pk2(s[2], s[3]);
            *(LAS u32x2*)(Ps + fr * ROWT + (16 * jt + 4 * fq) * 2) = o;
        }
        if ((rg & 1) == 0) *(LAS u32x2*)(Ps + fr * ROWT + (16 * (rg + 1) + 4 * fq) * 2) = (u32x2){0u, 0u};
        LDS_WAIT(); asm volatile("" ::: "memory");
        f32x4 ao[4];
#pragma unroll
        for (int et = 0; et < 4; ++et) ao[et] = (f32x4){0.f, 0.f, 0.f, 0.f};
        const int nks = (rg + 2) >> 1;
        for (int ks = 0; ks < nks; ++ks) {
            const bf16x8 bp = *(const LAS bf16x8*)(Ps + fr * ROWT + (32 * ks + 8 * fq) * 2);
#pragma unroll
            for (int et = 0; et < 4; ++et) ao[et] = mfma16(*(const LAS bf16x8*)(VT + (16 * et + fr) * ROWT + (32 * ks + 8 * fq) * 2), bp, ao[et]);
        }
#pragma unroll
        for (int ks = 0; ks < 2; ++ks)
#pragma unroll
            for (int et = 0; et < 4; ++et) ao[et] = mfma16(*(const LAS bf16x8*)(SgT + (16 * et + fr) * ROWB + (32 * ks + 8 * fq) * 2), bq[ks], ao[et]);
        const int il = 16 * rg + fr;
        const float sc = exp2f(-(float)il * nl2g(h));
        float s1 = 0.f;
#pragma unroll
        for (int et = 0; et < 4; ++et) { ao[et] = ao[et] * sc; s1 += (ao[et][0] + ao[et][1]) + (ao[et][2] + ao[et][3]); }
        s1 += __shfl_xor(s1, 16); s1 += __shfl_xor(s1, 32);
        const float mu = s1 * (1.f / 64.f); float s2 = 0.f;
#pragma unroll
        for (int et = 0; et < 4; ++et) { ao[et] = ao[et] - mu; s2 += (ao[et][0] * ao[et][0] + ao[et][1] * ao[et][1]) + (ao[et][2] * ao[et][2] + ao[et][3] * ao[et][3]); }
        s2 += __shfl_xor(s2, 16); s2 += __shfl_xor(s2, 32);
        const float rstd = 1.0f / sqrtf(s2 * (1.f / 64.f) + GN_EPS);
        const size_t r = (size_t)b * LP + 128 * c - 112 + il, r2 = (size_t)b * SEQ + 128 * (c - 1) + il;
#pragma unroll
        for (int et = 0; et < 4; ++et) { const int e0 = h * 64 + 16 * et + 4 * fq;
            const u32x2 gv = *(const u32x2*)(Z + r * ZC + ZG + e0); const f32x4 gn = *(const f32x4*)(p.ret_norm_g + e0);
            const float o0 = bf2f(gv.x & 0xffffu) * (ao[et][0] * rstd * gn[0]), o1 = bf2f(gv.x >> 16) * (ao[et][1] * rstd * gn[1]);
            const float o2 = bf2f(gv.y & 0xffffu) * (ao[et][2] * rstd * gn[2]), o3 = bf2f(gv.y >> 16) * (ao[et][3] * rstd * gn[3]);
            u32x2 ov; ov.x = pk2(o0, o1); ov.y = pk2(o2, o3); *(u32x2*)(MIX + r2 * D + 512 + e0) = ov; }
        LDS_WAIT(); __builtin_amdgcn_s_barrier(); asm volatile("" ::: "memory");
    }
}

constexpr int N_PHASES = 8;
struct Args { Ptrs p; int ph_lo, ph_hi, use_bar, pad; };
__global__ void __launch_bounds__(NWAVES * 64, 2) mk_fwd(Args args) {
    extern __shared__ __attribute__((aligned(16))) unsigned char lds[];
    Frame F;
    F.lds = (LAS unsigned char*)lds;
    F.MISC = (volatile LAS unsigned*)(F.lds + MISC_OFF);
    F.tid = threadIdx.x; F.lane = F.tid & 63; F.wave = __builtin_amdgcn_readfirstlane(F.tid >> 6);
    F.G = gridDim.x; { const int bx = blockIdx.x; F.vcu = (F.G % 8 == 0) ? (bx % 8) * (F.G / 8) + bx / 8 : bx; }
    const Ptrs& p = args.p;
    F.ctl = (gu32*)(p.ws + WS_CTL);
    for (int u = F.tid; u < (LDS_BYTES - LDSCTL_OFF) / 4; u += NWAVES * 64) ((LAS unsigned*)(F.lds + LDSCTL_OFF))[u] = 0u;
    __syncthreads();
    XcdBarrier bar; bar.bar = (unsigned*)(F.ctl + CW_BAR); bar.x = 0; bar.st = nullptr;
    if (args.use_bar) bar = xcd_barrier_post((unsigned*)(F.ctl + CW_BAR), F.MISC + 8);
    const int lo = args.ph_lo, hi = args.ph_hi;
#define IN(k) (lo <= (k) && (k) < hi)
#define SEAM(k) do { if (IN(k) && IN((k) + 1)) xcd_barrier(bar); } while (0)
    if (IN(0)) { p0_prologue(F, p); } SEAM(0);
    if (IN(1)) { pg8::Gemm g{(const bf16_t*)(p.ws + WS_XN), (const bf16_t*)(p.ws + WS_WIN), M1P, NIN, D}; pg8::StaticOrder S; S.init(M1P, NIN, F.G, (int)blockIdx.x);
        pg8::gemm_phase<FEpiZ, pg8::StaticOrder, true, true>(F.lds + RING_OFF, g, S, FEpiZ{p}); } SEAM(1);
    if (IN(2)) { phase_p2a(F, p); } SEAM(2);
    if (IN(3)) { phase_p2b(F, p); } SEAM(3);
    if (IN(4)) { pg8::Gemm g{(const bf16_t*)(p.ws + WS_MIX), (const bf16_t*)(p.ws + WS_WOUT), M2, D, D}; pg8::StaticOrder S; S.init(M2, D, F.G, (int)blockIdx.x);
        pg8::gemm_phase<FEpiX1, pg8::StaticOrder, true, true>(F.lds + RING_OFF, g, S, FEpiX1{p}); } SEAM(4);
    if (IN(5)) { pg8::Gemm g{(const bf16_t*)(p.ws + WS_X1B), (const bf16_t*)(p.ws + WS_WGU), M2, NGU, D}; pg8::StaticOrder S; S.init(M2, NGU, F.G, (int)blockIdx.x);
        pg8::gemm_phase<FEpiGU, pg8::StaticOrder, true, true>(F.lds + RING_OFF, g, S, FEpiGU{p}); } SEAM(5);
    if (IN(6)) { pg8::Gemm g{(const bf16_t*)(p.ws + WS_ACT), (const bf16_t*)(p.ws + WS_WDN), M2, D, FF}; pg8::StaticOrder S; S.init(M2, D, F.G, (int)blockIdx.x);
        pg8::gemm_phase<FEpiX2, pg8::StaticOrder, true, true>(F.lds + RING_OFF, g, S, FEpiX2{p}); } SEAM(6);
    if (IN(7)) { p_final(F, p); }
#undef IN
#undef SEAM
}

static void launch_mk(const Ptrs& p, int lo, int hi, int grid, hipStream_t stream) {
    Args a{}; a.p = p; a.ph_lo = lo; a.ph_hi = hi; a.use_bar = (hi - lo > 1) ? 1 : 0; a.pad = 0;
    hipLaunchKernelGGL(mk_fwd, dim3(grid), dim3(NWAVES * 64), LDS_BYTES, stream, a);
}
extern "C" void kernel_launch(void* const* d_in, const int* in_sizes, int n_in, void* d_out, int out_size, void* d_ws, size_t ws_size, hipStream_t stream) {
    Ptrs p{};
    p.x_prompt = (const float*)d_in[0]; p.x_sample = (const float*)d_in[1]; p.state_conv = (const float*)d_in[2]; p.state_ret = (const float*)d_in[3]; p.meta = (const float*)d_in[4];
    p.norm1_g = (const float*)d_in[5]; p.w_in = (const float*)d_in[6]; p.w_conv = (const float*)d_in[7]; p.ret_norm_g = (const float*)d_in[8]; p.w_out = (const float*)d_in[9];
    p.norm2_g = (const float*)d_in[10]; p.w_gate = (const float*)d_in[11]; p.w_up = (const float*)d_in[12]; p.w_down = (const float*)d_in[13]; p.final_g = (const float*)d_in[14];
    p.out = (float*)d_out; p.ws = (unsigned char*)d_ws;
    static int grid = 0;
    if (grid == 0) {
        if (ws_size < WS_END) { fprintf(stderr, "kernel_launch: workspace too small: %zu < %zu\n", ws_size, (size_t)WS_END); grid = -1; return; }
        int dev = 0, cus = 0, per_cu = 0;
        if (hipGetDevice(&dev) != hipSuccess || hipDeviceGetAttribute(&cus, hipDeviceAttributeMultiprocessorCount, dev) != hipSuccess) { grid = -1; return; }
        if (hipFuncSetAttribute((const void*)mk_fwd, hipFuncAttributeMaxDynamicSharedMemorySize, LDS_BYTES) != hipSuccess) { fprintf(stderr, "kernel_launch: hipFuncSetAttribute failed\n"); grid = -1; return; }
        if (hipOccupancyMaxActiveBlocksPerMultiprocessor(&per_cu, (const void*)mk_fwd, NWAVES * 64, LDS_BYTES) != hipSuccess || per_cu < 1) { fprintf(stderr, "kernel_launch: occupancy query says %d\n", per_cu); per_cu = 1; }
        (void)hipGetLastError();
        grid = cus * 1;
    }
    if (grid < 0) return;
    (void)hipMemsetAsync((char*)d_ws + WS_CTL, 0, CTL_ZERO_BYTES, stream);
    const dim3 blk(256);
    constexpr bool ONE_LAUNCH = true;
    if (ONE_LAUNCH) { launch_mk(p, 0, N_PHASES, grid, stream); return; }
    constexpr bool FAST_P0 = true, FAST_G1 = true, FAST_RET = true, FAST_G2 = true, FAST_G3 = true, FAST_G4 = true, FAST_FIN = true;
    const bf16_t* XN = (const bf16_t*)(p.ws + WS_XN); const bf16_t* MIX = (const bf16_t*)(p.ws + WS_MIX); const bf16_t* X1B = (const bf16_t*)(p.ws + WS_X1B); const bf16_t* ACT = (const bf16_t*)(p.ws + WS_ACT);
    const bf16_t* WIN = (const bf16_t*)(p.ws + WS_WIN); const bf16_t* WOUT = (const bf16_t*)(p.ws + WS_WOUT); const bf16_t* WGU = (const bf16_t*)(p.ws + WS_WGU); const bf16_t* WDN = (const bf16_t*)(p.ws + WS_WDN);
    if (FAST_P0) launch_mk(p, 0, 1, grid, stream);
    else { simple::k_prep_w<<<(unsigned)((simple::PREP_W_ELEMS + 255) / 256), blk, 0, stream>>>(p); simple::k_xn<<<(M1P * 64 + 255) / 256, blk, 0, stream>>>(p); simple::k_rope_table<<<(NPOS * 32 + 255) / 256, blk, 0, stream>>>(p); }
    if (FAST_G1) launch_mk(p, 1, 2, grid, stream); else simple::k_gemm<simple::EpiZ><<<dim3(NIN / 256 * 4, M1P / 64), blk, 0, stream>>>(XN, WIN, D, simple::EpiZ{p});
    if (FAST_RET) { launch_mk(p, 2, 3, grid, stream); launch_mk(p, 3, 4, grid, stream); }
    else { simple::k_conv<<<(M1 * 512 + 255) / 256, blk, 0, stream>>>(p); simple::k_retention<<<BATCH * RH + DECB * RH, blk, 0, stream>>>(p); }
    if (FAST_G2) launch_mk(p, 4, 5, grid, stream); else simple::k_gemm<simple::EpiX1><<<dim3(D / 256 * 4, M2 / 64), blk, 0, stream>>>(MIX, WOUT, D, simple::EpiX1{p});
    if (FAST_G3) launch_mk(p, 5, 6, grid, stream); else simple::k_gemm<simple::EpiGU><<<dim3(NGU / 256 * 4, M2 / 64), blk, 0, stream>>>(X1B, WGU, D, simple::EpiGU{p});
    if (FAST_G4) launch_mk(p, 6, 7, grid, stream); else simple::k_gemm<simple::EpiX2><<<dim3(D / 256 * 4, M2 / 64), blk, 0, stream>>>(ACT, WDN, FF, simple::EpiX2{p});
    if (FAST_FIN) launch_mk(p, 7, 8, grid, stream); else simple::k_final<<<(M2 * 64 + 255) / 256, blk, 0, stream>>>(p);
}
```
